# Optimizing an MI355X kernel written in HIP

```python
import math
import jax, jax.numpy as jnp
from jax import lax
import numpy as np

D_MODEL = 1024
BATCH = 32
SEQ = 2048
DEPTH = 1

CTX_LEN = 256
GRID_W = 64
CHUNK = 2 * GRID_W
ROWS_PER_CHUNK = CHUNK // GRID_W
D_SSM = D_MODEL // 2
SSM_GROUP = 16
N_SSM_GROUPS = D_SSM // SSM_GROUP
SSM_STATE = 64
D_SGU = D_MODEL // 2
N_SGU_GROUPS = 8
SGU_GROUP = D_SGU // N_SGU_GROUPS
D_IN = 2 * D_SSM + 3 * D_SGU + 2 * D_MODEL
DEEPNORM_ALPHA = (2.0 * DEPTH) ** 0.25
DEEPNORM_BETA = (8.0 * DEPTH) ** -0.25
LN_EPS = 1e-6
DT_MIN = 1e-3
DT_MAX = 1e-1

kernel_name = 'hybrid_s5_sgu_parallel_gated_prefix_dit'


def _layer_norm(x):
    x32 = x.astype(jnp.float32)
    mu = jnp.mean(x32, axis=-1, keepdims=True)
    var = jnp.mean(jnp.square(x32 - mu), axis=-1, keepdims=True)
    return ((x32 - mu) * lax.rsqrt(var + LN_EPS)).astype(x.dtype)


def _discretise(lam_re, lam_im, log_dt, b_re, b_im):
    f32 = jnp.float32
    lam_re, lam_im, log_dt = lam_re.astype(f32), lam_im.astype(f32), log_dt.astype(f32)
    b_re, b_im = b_re.astype(f32), b_im.astype(f32)
    dt = jnp.exp(log_dt)[:, None]
    mag = jnp.exp(lam_re * dt)
    ar = mag * jnp.cos(lam_im * dt)
    ai = mag * jnp.sin(lam_im * dt)
    den = lam_re * lam_re + lam_im * lam_im
    nr = ar - 1.0
    fr = (nr * lam_re + ai * lam_im) / den
    fi = (ai * lam_re - nr * lam_im) / den
    bbr = fr[..., None] * b_re - fi[..., None] * b_im
    bbi = fr[..., None] * b_im + fi[..., None] * b_re
    return ar, ai, bbr, bbi


def _complex_affine_combine(e1, e2):
    a1r, a1i, b1r, b1i = e1
    a2r, a2i, b2r, b2i = e2
    return (a1r * a2r - a1i * a2i,
            a1r * a2i + a1i * a2r,
            a2r * b1r - a2i * b1i + b2r,
            a2r * b1i + a2i * b1r + b2i)


def _s5_bidir(u, discs, c_re, c_im, d_skip, h0s, readout):
    bsz, n, _ = u.shape
    ug = u.astype(jnp.float32).reshape(bsz, n, N_SSM_GROUPS, SSM_GROUP)
    y = d_skip.astype(jnp.float32).reshape(N_SSM_GROUPS, SSM_GROUP) * ug if readout else None
    finals = []
    for k, reverse in enumerate((False, True)):
        ar, ai, bbr, bbi = discs[k]
        bu_r = jnp.einsum('blgh,gph->blgp', ug, bbr)
        bu_i = jnp.einsum('blgh,gph->blgp', ug, bbi)
        if h0s is not None:
            h_r, h_i = h0s[k]
            first = n - 1 if reverse else 0
            bu_r = bu_r.at[:, first].add(ar * h_r - ai * h_i)
            bu_i = bu_i.at[:, first].add(ar * h_i + ai * h_r)
        a_r = jnp.broadcast_to(ar, (1, n) + ar.shape)
        a_i = jnp.broadcast_to(ai, (1, n) + ai.shape)
        _, _, s_r, s_i = lax.associative_scan(_complex_affine_combine, (a_r, a_i, bu_r, bu_i),
                                              reverse=reverse, axis=1)
        last = 0 if reverse else n - 1
        finals.append((s_r[:, last], s_i[:, last]))
        if readout:
            y = (y + jnp.einsum('blgp,ghp->blgh', s_r, c_re[k].astype(jnp.float32))
                 - jnp.einsum('blgp,ghp->blgh', s_i, c_im[k].astype(jnp.float32)))
    if readout:
        y = y.reshape(bsz, n, D_SSM)
    return y, finals


def _ssm_glu_gate(y, z, glu_w, glu_b):
    g = jax.nn.gelu(y.astype(z.dtype))
    return g * jax.nn.sigmoid(g @ glu_w + glu_b) * jax.nn.silu(z)


def _sgu_branch(u, v, z, ln_g, ln_b, w_s, b_s, n_chunks):
    bsz, n, _ = u.shape
    u = jax.nn.gelu(u)
    v = _layer_norm(jax.nn.gelu(v)) * ln_g + ln_b
    vg = v.reshape(bsz, n_chunks, CHUNK, N_SGU_GROUPS, SGU_GROUP)
    vm = jnp.einsum('gnm,bkmgc->bkngc', w_s, vg) + b_s.T[None, None, :, :, None]
    return u * vm.reshape(bsz, n, D_SGU) * jax.nn.silu(z)


def _split_proj(p):
    o = np.cumsum([0, D_SSM, D_SSM, D_SGU, D_SGU, D_SGU, D_MODEL, D_MODEL])
    return [p[..., o[j]:o[j + 1]] for j in range(7)]


def _merge_out(ya, yb, ga, gb, w_a, w_b, w_o, b_o):
    m = jax.nn.sigmoid(ga) * (ya @ w_a) + jax.nn.sigmoid(gb) * (yb @ w_b)
    return m @ w_o + b_o


def setup_inputs(seed: int = 0) -> dict:
    key = jax.random.key(seed)
    ks = jax.random.split(key, 32)
    nrm = lambda k, shape, s: jax.random.normal(k, shape, jnp.float32) * s
    G, P, H = N_SSM_GROUPS, SSM_STATE, SSM_GROUP
    lam_im0 = math.pi * jnp.arange(P, dtype=jnp.float32)
    return {
        'x': nrm(ks[0], (BATCH, SEQ, D_MODEL), 1.0),
        'c': nrm(ks[1], (BATCH, D_MODEL), 1.0),
        'ctx': nrm(ks[2], (BATCH, CTX_LEN, D_MODEL), 1.0),
        'c_ctx': nrm(ks[3], (D_MODEL,), 1.0),
        'w_mod': nrm(ks[4], (DEPTH, D_MODEL, 3 * D_MODEL), 0.5 * D_MODEL ** -0.5),
        'b_mod': nrm(ks[5], (DEPTH, 3 * D_MODEL), 0.01),
        'w_in': nrm(ks[6], (DEPTH, D_MODEL, D_IN), D_MODEL ** -0.5),
        'b_in': nrm(ks[7], (DEPTH, D_IN), 0.01),
        'ssm_lam_re': -0.5 + nrm(ks[8], (DEPTH, 2, G, P), 0.01),
        'ssm_lam_im': lam_im0 + nrm(ks[9], (DEPTH, 2, G, P), 0.01),
        'ssm_log_dt': jax.random.uniform(ks[10], (DEPTH, 2, G), jnp.float32,
                                         math.log(DT_MIN), math.log(DT_MAX)),
        'ssm_b_re': nrm(ks[11], (DEPTH, 2, G, P, H), (2.0 * H) ** -0.5),
        'ssm_b_im': nrm(ks[12], (DEPTH, 2, G, P, H), (2.0 * H) ** -0.5),
        'ssm_c_re': nrm(ks[13], (DEPTH, 2, G, H, P), (2.0 * P) ** -0.5),
        'ssm_c_im': nrm(ks[14], (DEPTH, 2, G, H, P), (2.0 * P) ** -0.5),
        'ssm_d': nrm(ks[15], (DEPTH, D_SSM), 1.0),
        'glu_w': nrm(ks[16], (DEPTH, D_SSM, D_SSM), D_SSM ** -0.5),
        'glu_b': nrm(ks[17], (DEPTH, D_SSM), 0.01),
        'sgu_ln_g': 1.0 + nrm(ks[18], (DEPTH, D_SGU), 0.05),
        'sgu_ln_b': nrm(ks[19], (DEPTH, D_SGU), 0.01),
        'sgu_w': nrm(ks[20], (DEPTH, N_SGU_GROUPS, CHUNK, CHUNK), CHUNK ** -0.5),
        'sgu_b': 1.0 + nrm(ks[21], (DEPTH, N_SGU_GROUPS, CHUNK), 0.05),
        'w_branch_a': nrm(ks[22], (DEPTH, D_SSM, D_MODEL), DEEPNORM_BETA * D_SSM ** -0.5),
        'w_branch_b': nrm(ks[23], (DEPTH, D_SGU, D_MODEL), DEEPNORM_BETA * D_SGU ** -0.5),
        'w_out': nrm(ks[24], (DEPTH, D_MODEL, D_MODEL), DEEPNORM_BETA * D_MODEL ** -0.5),
        'b_out': nrm(ks[25], (DEPTH, D_MODEL), 0.01),
        'ln_g': 1.0 + nrm(ks[26], (DEPTH, D_MODEL), 0.05),
        'ln_b': nrm(ks[27], (DEPTH, D_MODEL), 0.01),
    }


def reference(x, c, ctx, c_ctx, w_mod, b_mod, w_in, b_in, ssm_lam_re, ssm_lam_im, ssm_log_dt,
              ssm_b_re, ssm_b_im, ssm_c_re, ssm_c_im, ssm_d, glu_w, glu_b, sgu_ln_g, sgu_ln_b,
              sgu_w, sgu_b, w_branch_a, w_branch_b, w_out, b_out, ln_g, ln_b):
    n_lat = x.shape[1]
    rows = n_lat // GRID_W
    lat_chunks = rows // ROWS_PER_CHUNK
    ctx_chunks = ctx.shape[1] // CHUNK
    for i in range(DEPTH):
        is_last = i == DEPTH - 1
        shift, scale, gate = jnp.split(jax.nn.silu(c) @ w_mod[i] + b_mod[i], 3, axis=-1)
        mod_c = jax.nn.silu(c_ctx) @ w_mod[i] + b_mod[i]
        h = _layer_norm(x) * (1.0 + scale[:, None]) + shift[:, None]
        hc = _layer_norm(ctx) * (1.0 + mod_c[D_MODEL:2 * D_MODEL]) + mod_c[:D_MODEL]

        discs = [_discretise(ssm_lam_re[i, k], ssm_lam_im[i, k], ssm_log_dt[i, k],
                             ssm_b_re[i, k], ssm_b_im[i, k]) for k in range(2)]

        if is_last:
            u_ctx = hc @ w_in[i][:, :D_SSM] + b_in[i][:D_SSM]
            _, ctx_final = _s5_bidir(u_ctx, discs, ssm_c_re[i], ssm_c_im[i], ssm_d[i], None, False)
        else:
            ua_c, za_c, ub_c, vb_c, zb_c, ga_c, gb_c = _split_proj(hc @ w_in[i] + b_in[i])
            y_c, ctx_final = _s5_bidir(ua_c, discs, ssm_c_re[i], ssm_c_im[i], ssm_d[i], None, True)
            ya_c = _ssm_glu_gate(y_c, za_c, glu_w[i], glu_b[i])
            yb_c = _sgu_branch(ub_c, vb_c, zb_c, sgu_ln_g[i], sgu_ln_b[i], sgu_w[i], sgu_b[i], ctx_chunks)
            out_c = _merge_out(ya_c, yb_c, ga_c, gb_c, w_branch_a[i], w_branch_b[i], w_out[i], b_out[i])
            ctx_next = _layer_norm(DEEPNORM_ALPHA * ctx + mod_c[2 * D_MODEL:] * out_c) * ln_g[i] + ln_b[i]

        ua, za, ub, vb, zb, ga, gb = _split_proj(h @ w_in[i] + b_in[i])
        y_a, _ = _s5_bidir(ua, discs, ssm_c_re[i], ssm_c_im[i], ssm_d[i], ctx_final, True)
        ya = _ssm_glu_gate(y_a, za, glu_w[i], glu_b[i])
        yb = _sgu_branch(ub, vb, zb, sgu_ln_g[i], sgu_ln_b[i], sgu_w[i], sgu_b[i], lat_chunks)
        out = _merge_out(ya, yb, ga, gb, w_branch_a[i], w_branch_b[i], w_out[i], b_out[i])
        x = _layer_norm(DEEPNORM_ALPHA * x + gate[:, None] * out) * ln_g[i] + ln_b[i]
        if not is_last:
            ctx = ctx_next
    return x
```

```cpp
#include <hip/hip_runtime.h>
#include <cstdio>
#include <cstdint>

#ifndef MK_N_LAUNCHES
#define MK_N_LAUNCHES 11
#endif

namespace pg8 {
#define PG8_LAS __attribute__((address_space(3)))
typedef unsigned short bf16_t;
typedef short bf16x8 __attribute__((ext_vector_type(8)));
typedef float f32x4 __attribute__((ext_vector_type(4)));
typedef float f32x2 __attribute__((ext_vector_type(2)));
typedef unsigned u32x4 __attribute__((ext_vector_type(4)));
typedef unsigned u32x2 __attribute__((ext_vector_type(2)));
constexpr int BM = 256, BK = 64, HALF = 128, HTB = HALF * BK * 2, STAGE_BYTES = 8 * HTB, NXCD = 8, WGM = 8;

__host__ __device__ __forceinline__ int lds_byte(int r, int c) { const int st = (r >> 4) * 2 + (c >> 5), rr = r & 15, cc = c & 31, ob = rr * 64 + cc * 2; return st * 1024 + (ob ^ (((ob >> 9) & 1) << 5)); }
__host__ __device__ __forceinline__ void stage_rc(int b, int& R, int& C) { const int st = b / 1024, sb = b % 1024, swz = sb ^ (((sb >> 9) & 1) << 5); R = (st >> 1) * 16 + swz / 64; C = (st & 1) * 32 + (swz % 64) / 2; }
__host__ __device__ __forceinline__ int perm32(int rho) { const int n = rho >> 4, i = rho & 15; return 8 * (i >> 2) + 4 * n + (i & 3); }

struct Unit { int pm, pn; };
struct Gemm { const char* A; const char* Bt; };

struct StaticOrder {
    int nM, nN, nwg, G, c;
    __host__ __device__ void init(int M, int N, int G_, int c_) { nM = M / BM; nN = N / BM; nwg = nM * nN; G = G_; c = c_; }
    __host__ __device__ void map(int L, Unit& u) const {
        int wgid = L; { const int q = nwg / NXCD, r = nwg % NXCD, xcd = wgid % NXCD, off = wgid / NXCD; wgid = (xcd < r ? xcd * (q + 1) : r * (q + 1) + (xcd - r) * q) + off; }
        const int nig = WGM * nN, gid = wgid / nig, fm = gid * WGM, gsz = (nM - fm) < WGM ? (nM - fm) : WGM;
        u.pm = fm + ((wgid % nig) % gsz); u.pn = (wgid % nig) / gsz;
    }
    __host__ __device__ bool next(int i, Unit& u) const { const long L = (long)i * G + c; if (L >= nwg) return false; map((int)L, u); return true; }
};

typedef __bf16 bf16n2 __attribute__((ext_vector_type(2)));
__device__ __forceinline__ unsigned cvt_pk_bf16(float lo, float hi) { return __builtin_bit_cast(unsigned, __builtin_convertvector((f32x2){lo, hi}, bf16n2)); }
__device__ __forceinline__ float bf_lo(unsigned w) { return __builtin_bit_cast(float, w << 16); }
__device__ __forceinline__ float bf_hi(unsigned w) { return __builtin_bit_cast(float, w & 0xffff0000u); }
__device__ __forceinline__ float sigmoidf_(float x) { return __builtin_amdgcn_rcpf(1.0f + __builtin_amdgcn_exp2f(-1.44269504089f * x)); }
__device__ __forceinline__ float siluf_(float x) { return x * sigmoidf_(x); }
__device__ __forceinline__ float geluf_(float x) { const float u = x * (1.5957691216f + 0.0713548163f * x * x); return x * sigmoidf_(u); }

template <class Epi, class Sched, bool ALIGN_EPI, int GK, unsigned A_ROW, unsigned A_GRP, unsigned LDB>
__device__ __forceinline__ void gemm_phase(PG8_LAS unsigned char* lds, const Gemm g, const Sched& S, const Epi& E) {
    const int tid = threadIdx.x, wid = __builtin_amdgcn_readfirstlane(tid >> 6), lane = tid & 63, wr = wid >> 2, wc = wid & 3, fr = lane & 15, fq = lane >> 4;
    constexpr int nt = GK / BK;
    unsigned voffA[2], voffB[2];
#pragma unroll
    for (int i = 0; i < 2; ++i) { int R, C; stage_rc(tid * 16 + i * 8192, R, C); const int Rb = Epi::PERM ? ((R & ~31) + perm32(R & 31)) : R;
        voffA[i] = (unsigned)R * A_ROW + (unsigned)(C >> 4) * A_GRP + (unsigned)(C & 15) * 2u; voffB[i] = ((unsigned)Rb * LDB + (unsigned)C) * 2u; }
    constexpr size_t kstepA = 4 * (size_t)A_GRP, hstepA = (size_t)HALF * A_ROW, tstepA = 2 * hstepA;
    constexpr size_t kstepB = (size_t)(BK * 2), hstepB = (size_t)HALF * LDB * 2, tstepB = 2 * hstepB;
    const unsigned ldsw = (unsigned)wid * 1024u;
    const int aoff = lds_byte(wr * 64 + fr, fq * 8), boff = lds_byte(wc * 32 + fr, fq * 8);
#define PG8_SA(b, h) (((b) * 2 + (h)) * HTB)
#define PG8_SB(b, h) ((4 + (b) * 2 + (h)) * HTB)
#define PG8_STAGE(bufoff, gbase, voff) do { _Pragma("unroll") for (int _i = 0; _i < 2; ++_i) \
        __builtin_amdgcn_global_load_lds((const unsigned*)((const char*)(gbase) + (voff)[_i]), (PG8_LAS unsigned*)(lds + (bufoff) + ldsw + _i * 8192), 16, 0, 0); } while (0)
#define PG8_LDA(dst, b, h) do { _Pragma("unroll") for (int m = 0; m < 4; ++m) _Pragma("unroll") for (int k = 0; k < 2; ++k) dst[m][k] = *(const PG8_LAS bf16x8*)(lds + PG8_SA(b, h) + aoff + m * 2048 + k * 1024); } while (0)
#define PG8_LDB(dst, b, h) do { _Pragma("unroll") for (int n = 0; n < 2; ++n) _Pragma("unroll") for (int k = 0; k < 2; ++k) dst[n][k] = *(const PG8_LAS bf16x8*)(lds + PG8_SB(b, h) + boff + n * 2048 + k * 1024); } while (0)
#define PG8_MMA(ai, bj, At, Bt) do { __builtin_amdgcn_s_setprio(1); _Pragma("unroll") for (int m = 0; m < 4; ++m) _Pragma("unroll") for (int n = 0; n < 2; ++n) _Pragma("unroll") for (int k = 0; k < 2; ++k) \
        acc[ai][bj][m][n] = __builtin_amdgcn_mfma_f32_16x16x32_bf16(Bt[n][k], At[m][k], acc[ai][bj][m][n], 0, 0, 0); __builtin_amdgcn_s_setprio(0); } while (0)
#define PG8_WAIT_V(n) asm volatile("s_waitcnt vmcnt(" #n ")" ::: "memory")
#define PG8_WAIT_L(n) asm volatile("s_waitcnt lgkmcnt(" #n ")" ::: "memory")
#define PG8_BAR __builtin_amdgcn_s_barrier()
#define PG8_SCHED __builtin_amdgcn_sched_barrier(0)
    Unit cur, nxt; int ui = 0;
    if (!S.next(0, cur)) return;
    f32x4 acc[2][2][4][2];
#pragma unroll
    for (int a = 0; a < 2; ++a)
#pragma unroll
        for (int b = 0; b < 2; ++b)
#pragma unroll
            for (int m = 0; m < 4; ++m)
#pragma unroll
                for (int n = 0; n < 2; ++n) acc[a][b][m][n] = (f32x4){0.f, 0.f, 0.f, 0.f};
    bf16x8 At[4][2], B0[2][2], B1[2][2];
    const char* cA = g.A + (size_t)cur.pm * tstepA; const char* cB = g.Bt + (size_t)cur.pn * tstepB;
    PG8_STAGE(PG8_SB(0, 0), cB, voffB); PG8_STAGE(PG8_SB(0, 1), cB + hstepB, voffB); PG8_STAGE(PG8_SA(0, 0), cA, voffA); PG8_STAGE(PG8_SA(0, 1), cA + hstepA, voffA);
    if (wr == 1) PG8_BAR;
    PG8_WAIT_V(2); PG8_BAR;
    PG8_STAGE(PG8_SB(1, 0), cB + kstepB, voffB); PG8_STAGE(PG8_SA(1, 0), cA + kstepA, voffA); PG8_STAGE(PG8_SB(1, 1), cB + hstepB + kstepB, voffB);
    PG8_WAIT_V(6); PG8_BAR;
    for (;;) {
        const bool has_next = S.next(ui + 1, nxt);
        const char* nA = has_next ? g.A + (size_t)nxt.pm * tstepA : cA; const char* nB = has_next ? g.Bt + (size_t)nxt.pn * tstepB : cB;
#pragma unroll 1
        for (int t = 0; t < nt; t += 2) {
            const bool last = (t == nt - 2);
            const char* a1 = cA + (size_t)(t + 1) * kstepA;
            const char* a2 = last ? nA : cA + (size_t)(t + 2) * kstepA; const char* b2 = last ? nB : cB + (size_t)(t + 2) * kstepB;
            const char* a3 = a2 + kstepA; const char* b3 = b2 + kstepB;
            PG8_LDB(B0, 0, 0); PG8_LDB(B1, 0, 1); PG8_SCHED; PG8_LDA(At, 0, 0); PG8_STAGE(PG8_SA(1, 1), a1 + hstepA, voffA);
            PG8_WAIT_V(8); PG8_WAIT_L(0); PG8_BAR; PG8_MMA(0, 0, At, B0); PG8_MMA(0, 1, At, B1); PG8_BAR; PG8_SCHED;
            PG8_LDA(At, 0, 1); PG8_STAGE(PG8_SB(0, 0), b2, voffB); PG8_STAGE(PG8_SB(0, 1), b2 + hstepB, voffB); PG8_STAGE(PG8_SA(0, 0), a2, voffA);
            PG8_WAIT_V(8); PG8_WAIT_L(0); PG8_BAR; PG8_MMA(1, 0, At, B0); PG8_MMA(1, 1, At, B1); PG8_BAR; PG8_SCHED;
            PG8_LDB(B0, 1, 0); PG8_LDB(B1, 1, 1); PG8_SCHED; PG8_LDA(At, 1, 0); PG8_STAGE(PG8_SA(0, 1), a2 + hstepA, voffA);
            PG8_WAIT_V(8); PG8_WAIT_L(0); PG8_BAR; PG8_MMA(0, 0, At, B0); PG8_MMA(0, 1, At, B1); PG8_BAR; PG8_SCHED;
            PG8_LDA(At, 1, 1); PG8_STAGE(PG8_SB(1, 0), b3, voffB); PG8_STAGE(PG8_SB(1, 1), b3 + hstepB, voffB); PG8_STAGE(PG8_SA(1, 0), a3, voffA);
            PG8_WAIT_V(8); PG8_WAIT_L(0); PG8_BAR; PG8_MMA(1, 0, At, B0); PG8_MMA(1, 1, At, B1); PG8_BAR; PG8_SCHED;
        }
        if constexpr (ALIGN_EPI) { if (wr == 0) PG8_BAR; }
        E(acc, cur, wr, wc, fr, fq);
        if (!has_next) break;
#pragma unroll
        for (int a = 0; a < 2; ++a)
#pragma unroll
            for (int b = 0; b < 2; ++b)
#pragma unroll
                for (int m = 0; m < 4; ++m)
#pragma unroll
                    for (int n = 0; n < 2; ++n) acc[a][b][m][n] = (f32x4){0.f, 0.f, 0.f, 0.f};
        cur = nxt; cA = nA; cB = nB; ++ui;
        if constexpr (ALIGN_EPI) { if (wr == 1) PG8_BAR; }
    }
    PG8_WAIT_V(0);
    if constexpr (!ALIGN_EPI) { if (wr == 0) PG8_BAR; }
    PG8_BAR;
#undef PG8_SA
#undef PG8_SB
#undef PG8_STAGE
#undef PG8_LDA
#undef PG8_LDB
#undef PG8_MMA
#undef PG8_WAIT_V
#undef PG8_WAIT_L
#undef PG8_BAR
#undef PG8_SCHED
}
}

constexpr int NWAVES = 8;
constexpr int DM = 1024, NB = 32, SEQ = 2048, NTOK = NB * SEQ, CTXL = 256, NCTX = NB * CTXL;
constexpr int DIN = 4608, DSSM = 512, NGRP = 32, HG = 16, PS = 64, NSG = 8, SGW = 64, CHK = 128;
constexpr int NINST = 4608;
constexpr int NCHUNK = NTOK / CHK;
constexpr float LN_EPS = 1e-6f, ALPHA = 1.189207115002721f;
constexpr int NPH = 11;
constexpr int N_LAUNCHES = MK_N_LAUNCHES;
static_assert(N_LAUNCHES == 1 || N_LAUNCHES == NPH, "MK_N_LAUNCHES is 1 or NPH");

constexpr size_t MiB = 1u << 20;
constexpr size_t WS_CTL = 0, CTL_ZERO_BYTES = 1 * MiB;
constexpr size_t WS_MOD = 1 * MiB;
constexpr size_t WS_BINP = 1 * MiB + 512 * 1024;
constexpr size_t WS_A16 = 1 * MiB + 576 * 1024;
constexpr size_t WS_KL = 2 * MiB;
constexpr size_t WS_WIN = 4 * MiB;
constexpr size_t WS_WGLU = 13 * MiB;
constexpr size_t WS_WSG = 13 * MiB + 512 * 1024;
constexpr size_t WS_WAB = 14 * MiB;
constexpr size_t WS_WO = 16 * MiB;
constexpr size_t WS_WSUM = 18 * MiB;
constexpr size_t WS_TG = 22 * MiB;
constexpr size_t WS_STATS = 30 * MiB;
constexpr size_t WS_H = 64 * MiB;
constexpr size_t WS_US = 208 * MiB;
constexpr size_t WS_SZA = 352 * MiB;
constexpr size_t WS_UZ = 416 * MiB;
constexpr size_t WS_GV = 480 * MiB;
constexpr size_t WS_SGA = 544 * MiB;
constexpr size_t WS_SGB = 672 * MiB;
constexpr size_t WS_YAB = 800 * MiB;
constexpr size_t WS_END = 928 * MiB;
constexpr int CW_BAR = 4096;

constexpr int RING_OFF = 0, RING_BYTES = 131072;
constexpr int LDSCTL_OFF = 139264, MISC_OFF = LDSCTL_OFF + 320;
constexpr int LDS_BYTES = 147456;
static_assert(MISC_OFF + 128 <= LDS_BYTES, "LDS map");

#define LAS __attribute__((address_space(3)))
typedef unsigned short bf16;
typedef unsigned v4u __attribute__((ext_vector_type(4)));
typedef unsigned v2u __attribute__((ext_vector_type(2)));
typedef float f32x4 __attribute__((ext_vector_type(4)));
typedef float f32x2 __attribute__((ext_vector_type(2)));
typedef float f32x16 __attribute__((ext_vector_type(16)));
typedef short bf16x8 __attribute__((ext_vector_type(8)));
#define LDS_WAIT() asm volatile("s_waitcnt lgkmcnt(0)" ::: "memory")
#define VM_WAIT() asm volatile("s_waitcnt vmcnt(0)" ::: "memory")
__device__ __forceinline__ unsigned f2bf(float f) { unsigned u = __builtin_bit_cast(unsigned, f); return (u + 0x7fffu + ((u >> 16) & 1u)) >> 16; }
__device__ __forceinline__ unsigned pk2(float lo, float hi) { return f2bf(lo) | (f2bf(hi) << 16); }
using pg8::bf_lo; using pg8::bf_hi; using pg8::sigmoidf_; using pg8::siluf_; using pg8::geluf_; using pg8::cvt_pk_bf16;

#define XB_TMO      128
#define XB_XCNT(j)  (256  + 64 * (j))
#define XB_XSUB(j)  (1280 + 64 * (j))
#define XB_XGEN(j)  (2304 + 64 * (j))
#define XB_TOP      3328
#define XB_TOPGEN   3392
#define XCD_BAR_WORDS 3456
#define XB_SPIN_CAP (1u << 18)
__device__ __forceinline__ unsigned xb_ld(unsigned* p)              { return __hip_atomic_load(p, __ATOMIC_RELAXED, __HIP_MEMORY_SCOPE_AGENT); }
__device__ __forceinline__ unsigned xb_add(unsigned* p, unsigned v) { return __hip_atomic_fetch_add(p, v, __ATOMIC_RELAXED, __HIP_MEMORY_SCOPE_AGENT); }
__device__ __forceinline__ unsigned xb_xcc_id() { return (unsigned)__builtin_amdgcn_s_getreg((3 << 11) | 20) & 0xFu; }
#define XB_SPIN(cond, bar) do { unsigned _sp = 0; while (cond) { __builtin_amdgcn_s_sleep(1); \
    if ((++_sp & 255u) == 0u) { if (xb_ld(&(bar)[XB_TMO])) break; if (_sp > XB_SPIN_CAP) { atomicAdd(&(bar)[XB_TMO], 1u); break; } } } } while (0)
struct XcdBarrier { unsigned* bar; unsigned x; volatile LAS unsigned* st; };
__device__ __forceinline__ XcdBarrier xcd_barrier_post(unsigned* bar, volatile LAS unsigned* st) {
    XcdBarrier b; b.bar = bar; b.x = xb_xcc_id(); b.st = st;
    if (threadIdx.x == 0) (void)xb_add(&bar[XB_XCNT(b.x)], 1u);
    return b;
}
__device__ __forceinline__ void xcd_barrier_complete(unsigned* bar, unsigned x, unsigned& nloc, unsigned& nx) {
    const unsigned G = gridDim.x * gridDim.y * gridDim.z;
    unsigned sum, cnt, mine, sp = 0u;
    for (;;) {
        sum = 0u; cnt = 0u; mine = 0u;
#pragma unroll
        for (unsigned j = 0; j < 16; ++j) { const unsigned c = xb_ld(&bar[XB_XCNT(j)]); sum += c; cnt += (c > 0u) ? 1u : 0u; mine = (j == x) ? c : mine; }
        if (sum == G) break;
        __builtin_amdgcn_s_sleep(1);
        if ((++sp & 255u) == 0u) { if (xb_ld(&bar[XB_TMO])) break; if (sp > XB_SPIN_CAP) { atomicAdd(&bar[XB_TMO], 1u); break; } }
    }
    nloc = mine > 0u ? mine : 1u; nx = cnt > 0u ? cnt : 1u;
}
__device__ __forceinline__ void xcd_barrier(const XcdBarrier& b) {
    asm volatile("s_waitcnt vmcnt(0)" ::: "memory");
    __syncthreads();
    if (threadIdx.x == 0) {
        unsigned* bar = b.bar;
        __builtin_amdgcn_s_waitcnt(0);
        unsigned nloc = b.st[0], nx = b.st[1];
        if (nloc == 0u) { xcd_barrier_complete(bar, b.x, nloc, nx); b.st[0] = nloc; b.st[1] = nx; }
        const unsigned old = xb_add(&bar[XB_XSUB(b.x)], 1u);
        const unsigned gen = old / nloc;
        if (old + 1u == (gen + 1u) * nloc) {
            __builtin_amdgcn_fence(__ATOMIC_RELEASE, "agent");
            asm volatile("s_waitcnt vmcnt(0)" ::: "memory");
            const unsigned og = xb_add(&bar[XB_TOP], 1u);
            const unsigned tg = og / nx;
            if (og + 1u == (tg + 1u) * nx) xb_add(&bar[XB_TOPGEN], 1u);
            else XB_SPIN(xb_ld(&bar[XB_TOPGEN]) == tg, bar);
            __builtin_amdgcn_fence(__ATOMIC_ACQUIRE, "agent");
            xb_add(&bar[XB_XGEN(b.x)], 1u);
            asm volatile("s_waitcnt vmcnt(0)" ::: "memory");
        } else {
            XB_SPIN(xb_ld(&bar[XB_XGEN(b.x)]) == gen, bar);
            __builtin_amdgcn_fence(__ATOMIC_ACQUIRE, "agent");
            asm volatile("s_waitcnt vmcnt(0)" ::: "memory");
        }
    }
    __syncthreads();
}

struct Args { const float* in[28]; float* out; unsigned char* ws; int ph_lo, ph_hi; };
struct Frame {
    LAS unsigned char* lds;
    volatile LAS unsigned* MISC;
    int tid, lane, wave, vcu, G;
};
enum { I_X = 0, I_C, I_CTX, I_CCTX, I_WMOD, I_BMOD, I_WIN, I_BIN, I_LRE, I_LIM, I_LDT, I_BRE, I_BIM, I_CRE, I_CIM, I_D, I_GLUW, I_GLUB, I_SLNG, I_SLNB, I_SGUW, I_SGUB, I_WA, I_WB, I_WO, I_BO, I_LNG, I_LNB };

__device__ __forceinline__ float wave_sum(float v) {
#pragma unroll
    for (int o = 1; o < 64; o <<= 1) v += __shfl_xor(v, o);
    return v;
}
__host__ __device__ __forceinline__ int win_src_col(int j) {
    if (j < 1024) return j;
    if (j < 2048) { const int q = (j - 1024) >> 8, w = (j - 1024) & 255; return w < 128 ? 1024 + 128 * q + w : 2048 + 128 * q + (w - 128); }
    if (j < 2560) return 1536 + (j - 2048);
    return j;
}
__device__ __forceinline__ void transpose_block(const float* W, int N, int k0, int n0, bf16* WT, int ld, int drow0, int koff, LAS float* scr, int lane) {
#pragma unroll 8
    for (int i = 0; i < 32; ++i) { const int kk = 2 * i + (lane >> 5); scr[kk * 33 + (lane & 31)] = W[(size_t)(k0 + kk) * N + n0 + (lane & 31)]; }
    LDS_WAIT(); asm volatile("" ::: "memory");
    const int c = lane & 7;
#pragma unroll
    for (int j = 0; j < 4; ++j) { const int n = (lane >> 3) + 8 * j; const LAS float* s = scr + (8 * c) * 33 + n;
        v4u o; o.x = pk2(s[0 * 33], s[1 * 33]); o.y = pk2(s[2 * 33], s[3 * 33]); o.z = pk2(s[4 * 33], s[5 * 33]); o.w = pk2(s[6 * 33], s[7 * 33]);
        *(v4u*)(WT + (size_t)(drow0 + n) * ld + koff + k0 + 8 * c) = o; }
    LDS_WAIT(); asm volatile("" ::: "memory");
}

__device__ __forceinline__ void p0_ssm_item(Frame& F, const Args& A, int gd) {
    const int k = gd >> 5, g = gd & 31, tid = F.tid;
    LAS float* APr = (LAS float*)(F.lds);
    LAS float* APi = APr + 17 * 64;
    LAS float* BBr = APi + 17 * 64;
    LAS float* BBi = BBr + 1024;
    LAS float* Cr = BBi + 1024;
    LAS float* Ci = Cr + 1024;
    const float* lre = A.in[I_LRE] + (k * 32 + g) * 64; const float* lim = A.in[I_LIM] + (k * 32 + g) * 64;
    const float dt = __builtin_amdgcn_exp2f(A.in[I_LDT][k * 32 + g] * 1.44269504089f);
    if (tid < 64) {
        const float lr = lre[tid], li = lim[tid];
        const float mag = __builtin_amdgcn_exp2f(lr * dt * 1.44269504089f);
        float rev = li * dt * 0.15915494309f; rev -= rintf(rev);
        const float ar = mag * __builtin_amdgcn_cosf(rev), ai = mag * __builtin_amdgcn_sinf(rev);
        float pr = 1.f, pi = 0.f;
        for (int l = 0; l <= 16; ++l) { APr[l * 64 + tid] = pr; APi[l * 64 + tid] = pi; const float nr = pr * ar - pi * ai, ni = pr * ai + pi * ar; pr = nr; pi = ni; }
        ((float*)(A.ws + WS_A16))[((k * 32 + g) * 64 + tid) * 2 + 0] = APr[16 * 64 + tid];
        ((float*)(A.ws + WS_A16))[((k * 32 + g) * 64 + tid) * 2 + 1] = APi[16 * 64 + tid];
    }
    for (int e = tid; e < 1024; e += NWAVES * 64) {
        const int p = e >> 4;
        const float lr = lre[p], li = lim[p];
        const float mag = __builtin_amdgcn_exp2f(lr * dt * 1.44269504089f);
        float rev = li * dt * 0.15915494309f; rev -= rintf(rev);
        const float ar = mag * __builtin_amdgcn_cosf(rev), ai = mag * __builtin_amdgcn_sinf(rev);
        const float den = lr * lr + li * li, nr = ar - 1.0f;
        const float fr = (nr * lr + ai * li) / den, fi = (ai * lr - nr * li) / den;
        const float br = A.in[I_BRE][((size_t)(k * 32 + g) * 64) * 16 + e], bi = A.in[I_BIM][((size_t)(k * 32 + g) * 64) * 16 + e];
        BBr[e] = fr * br - fi * bi; BBi[e] = fr * bi + fi * br;
        Cr[e] = A.in[I_CRE][(size_t)(k * 32 + g) * 1024 + e]; Ci[e] = A.in[I_CIM][(size_t)(k * 32 + g) * 1024 + e];
    }
    __syncthreads();
    bf16* wsum = (bf16*)(A.ws + WS_WSUM) + (size_t)g * 65536;
    for (int e = tid; e < 128 * 256; e += NWAVES * 64) {
        const int n = e >> 8, kk = e & 255, p = n & 63, im = n >> 6, j = kk >> 4, hh = kk & 15, l = k ? j : 15 - j;
        const float pr = APr[l * 64 + p], pi = APi[l * 64 + p], br = BBr[p * 16 + hh], bi = BBi[p * 16 + hh];
        const float v = im ? (pr * bi + pi * br) : (pr * br - pi * bi);
        wsum[(size_t)(k * 128 + n) * 256 + kk] = (bf16)f2bf(v);
    }
    float* kl = (float*)(A.ws + WS_KL) + (size_t)gd * 4096;
    for (int e = tid; e < 4096; e += NWAVES * 64) {
        const int l = e >> 8, h = (e >> 4) & 15, hh = e & 15; float s = 0.f;
        for (int p = 0; p < 64; ++p) {
            const float pr = APr[l * 64 + p], pi = APi[l * 64 + p], br = BBr[p * 16 + hh], bi = BBi[p * 16 + hh];
            const float tr = pr * br - pi * bi, ti = pr * bi + pi * br;
            s += Cr[h * 64 + p] * tr - Ci[h * 64 + p] * ti;
        }
        kl[e] = s;
    }
    bf16* tg = (bf16*)(A.ws + WS_TG) + (size_t)g * 256 * 512;
    for (int e = tid; e < 256 * 128; e += NWAVES * 64) {
        const int n = e >> 7, q = e & 127, p = q & 63, im = q >> 6, t = n >> 4, h = n & 15, ex = k ? 16 - t : t + 1;
        const float pr = APr[ex * 64 + p], pi = APi[ex * 64 + p], cr = Cr[h * 64 + p], ci = Ci[h * 64 + p];
        const float v = im ? -(cr * pi + ci * pr) : (cr * pr - ci * pi);
        tg[(size_t)n * 512 + 256 + k * 128 + q] = (bf16)f2bf(v);
    }
    __syncthreads();
}
__device__ __forceinline__ void p0_mod_item(Frame& F, const Args& A, int nb) {
    LAS float* SC = (LAS float*)(F.lds) + F.wave * (128 * 33);
    const int k0 = F.wave * 128, n0 = nb * 64;
    for (int idx = F.lane; idx < 128 * 33; idx += 64) { const int kk = idx / 33, r = idx - kk * 33;
        const float cv = r < 32 ? A.in[I_C][r * DM + k0 + kk] : A.in[I_CCTX][k0 + kk]; SC[idx] = siluf_(cv); }
    LDS_WAIT(); asm volatile("" ::: "memory");
    float acc[33];
#pragma unroll
    for (int r = 0; r < 33; ++r) acc[r] = 0.f;
    const float* wm = A.in[I_WMOD] + (size_t)k0 * 3072 + n0 + F.lane;
    for (int kk = 0; kk < 128; ++kk) { const float wv = wm[(size_t)kk * 3072];
#pragma unroll
        for (int r = 0; r < 33; ++r) acc[r] += SC[kk * 33 + r] * wv; }
    __syncthreads();
    LAS float* RED = (LAS float*)(F.lds);
#pragma unroll
    for (int r = 0; r < 33; ++r) RED[(F.wave * 33 + r) * 64 + F.lane] = acc[r];
    __syncthreads();
    for (int idx = F.tid; idx < 33 * 64; idx += NWAVES * 64) { const int r = idx >> 6, ln = idx & 63; float s = A.in[I_BMOD][n0 + ln];
#pragma unroll
        for (int w = 0; w < NWAVES; ++w) s += RED[(w * 33 + r) * 64 + ln];
        ((float*)(A.ws + WS_MOD))[r * 3072 + n0 + ln] = s; }
    __syncthreads();
}
__device__ __forceinline__ void p0_prep(Frame& F, const Args& A) {
    if (blockIdx.x < 64) p0_ssm_item(F, A, (int)blockIdx.x);
    else if (blockIdx.x < 64 + 48) p0_mod_item(F, A, (int)blockIdx.x - 64);
    else if (blockIdx.x == 64 + 48) { for (int j = F.tid; j < DIN; j += NWAVES * 64) ((float*)(A.ws + WS_BINP))[j] = A.in[I_BIN][win_src_col(j)]; }
    if (F.G < 113) {
        for (int it = (int)blockIdx.x + F.G; it < 113; it += F.G) { if (it < 64) p0_ssm_item(F, A, it); else if (it < 112) p0_mod_item(F, A, it - 64);
            else for (int j = F.tid; j < DIN; j += NWAVES * 64) ((float*)(A.ws + WS_BINP))[j] = A.in[I_BIN][win_src_col(j)]; } }
    __syncthreads();
    LAS float* scr = (LAS float*)(F.lds + RING_OFF + F.wave * 16384);
    const int gw = F.vcu * NWAVES + F.wave, NGW = F.G * NWAVES;
    constexpr int I_IN = (DM / 64) * (DIN / 32), I_GL = (512 / 64) * (512 / 32), I_A = (512 / 64) * (DM / 32), I_O = (DM / 64) * (DM / 32), I_SG = (NSG * 128 * 128) / 2048;
    constexpr int NITEMS = I_IN + I_GL + 2 * I_A + I_O + I_SG;
    for (int it = gw; it < NITEMS; it += NGW) {
        int r = it;
        if (r < I_IN) { const int nblk = DIN / 32, kb = r / nblk, db = r % nblk; transpose_block(A.in[I_WIN], DIN, 64 * kb, win_src_col(32 * db), (bf16*)(A.ws + WS_WIN), DM, 32 * db, 0, scr, F.lane); continue; } r -= I_IN;
        if (r < I_GL) { const int nblk = 512 / 32, kb = r / nblk, db = r % nblk; transpose_block(A.in[I_GLUW], 512, 64 * kb, 32 * db, (bf16*)(A.ws + WS_WGLU), 512, 32 * db, 0, scr, F.lane); continue; } r -= I_GL;
        if (r < I_A) { const int nblk = DM / 32, kb = r / nblk, db = r % nblk; transpose_block(A.in[I_WA], DM, 64 * kb, 32 * db, (bf16*)(A.ws + WS_WAB), 1024, 32 * db, 0, scr, F.lane); continue; } r -= I_A;
        if (r < I_A) { const int nblk = DM / 32, kb = r / nblk, db = r % nblk; transpose_block(A.in[I_WB], DM, 64 * kb, 32 * db, (bf16*)(A.ws + WS_WAB), 1024, 32 * db, 512, scr, F.lane); continue; } r -= I_A;
        if (r < I_O) { const int nblk = DM / 32, kb = r / nblk, db = r % nblk; transpose_block(A.in[I_WO], DM, 64 * kb, 32 * db, (bf16*)(A.ws + WS_WO), 1024, 32 * db, 0, scr, F.lane); continue; } r -= I_O;
        { const float* src = A.in[I_SGUW] + (size_t)r * 2048; bf16* dst = (bf16*)(A.ws + WS_WSG) + (size_t)r * 2048;
#pragma unroll
          for (int j = 0; j < 8; ++j) { const f32x4 v = *(const f32x4*)(src + j * 256 + F.lane * 4); v2u o; o.x = pk2(v.x, v.y); o.y = pk2(v.z, v.w); *(v2u*)(dst + j * 256 + F.lane * 4) = o; } }
    }
}
__device__ __forceinline__ void ln_row_mod_to_bf16(Frame& F, const float* xrow, const float* modrow, bf16* orow) {
    const f32x4* xr = (const f32x4*)xrow + F.lane;
    f32x4 v[4]; float s = 0.f;
#pragma unroll
    for (int j = 0; j < 4; ++j) { v[j] = xr[64 * j]; s += (v[j].x + v[j].y) + (v[j].z + v[j].w); }
    const float mean = wave_sum(s) * (1.f / DM); float s2 = 0.f;
#pragma unroll
    for (int j = 0; j < 4; ++j) { v[j] = v[j] - mean; s2 += (v[j].x * v[j].x + v[j].y * v[j].y) + (v[j].z * v[j].z + v[j].w * v[j].w); }
    const float rstd = 1.f / sqrtf(wave_sum(s2) * (1.f / DM) + LN_EPS);
    unsigned long long* o8 = (unsigned long long*)orow + F.lane;
#pragma unroll
    for (int j = 0; j < 4; ++j) { const f32x4 sh = *((const f32x4*)modrow + F.lane + 64 * j), sc = *((const f32x4*)(modrow + DM) + F.lane + 64 * j);
        const f32x4 h = v[j] * rstd * (sc + 1.0f) + sh;
        o8[64 * j] = (unsigned long long)pk2(h.x, h.y) | ((unsigned long long)pk2(h.z, h.w) << 32); }
}
__device__ __forceinline__ void p1_rows(Frame& F, const Args& A) {
    const int gt = F.vcu * NWAVES * 64 + F.tid, NT = F.G * NWAVES * 64;
    const float* kl = (const float*)(A.ws + WS_KL); const float* dsk = A.in[I_D];
    for (int e = gt; e < NGRP * 256 * 256; e += NT) {
        const int g = e >> 16, n = (e >> 8) & 255, kk = e & 255, t = n >> 4, h = n & 15, j = kk >> 4, hh = kk & 15;
        float v = (j == t && h == hh) ? dsk[g * 16 + h] : 0.f;
        if (j <= t) v += kl[(((size_t)g * 16 + (t - j)) * 16 + h) * 16 + hh];
        if (j >= t) v += kl[(((size_t)(32 + g) * 16 + (j - t)) * 16 + h) * 16 + hh];
        ((bf16*)(A.ws + WS_TG))[((size_t)g * 256 + n) * 512 + kk] = (bf16)f2bf(v);
    }
    const int gw = F.vcu * NWAVES + F.wave, NGW = F.G * NWAVES;
    const float* mod = (const float*)(A.ws + WS_MOD); bf16* H = (bf16*)(A.ws + WS_H);
    for (int m = gw; m < NTOK + NCTX; m += NGW) {
        if (m < NTOK) ln_row_mod_to_bf16(F, A.in[I_X] + (size_t)m * DM, mod + (size_t)(m >> 11) * 3072, H + (size_t)m * DM);
        else ln_row_mod_to_bf16(F, A.in[I_CTX] + (size_t)(m - NTOK) * DM, mod + (size_t)32 * 3072, H + (size_t)m * DM);
    }
}

using pg8::Unit; using pg8::HALF; using pg8::BM;
struct SchedIn {
    pg8::StaticOrder so; int G, c;
    __device__ __forceinline__ bool next(int i, Unit& u) const { const int L = i * G + c;
#if defined(DBG_PLAINONLY)
        if (L < 2560) { so.map(L, u); u.pn = u.pn < 2 ? u.pn + 2 : u.pn + 8; return true; }
        return false;
#endif
        if (L < 4608) { so.map(L, u); return true; }
        if (L < 4608 + 64) { const int idx = L - 4608; u.pm = 256 + (idx & 31); u.pn = idx >> 5; return true; }
        return false; }
};
struct SchedGrp {
    int G, c, cnt, off, n;
    __device__ __forceinline__ bool next(int i, Unit& u) const { const int L = i * G + c; if (L >= n) return false; const int g = L / cnt, j = L - g * cnt; u.pm = g * 18 + off + j; u.pn = g; return true; }
};
#define EPI_ARGS const f32x4 (&acc)[2][2][4][2], const Unit& u, int wr, int wc, int fr, int fq
#define EPI_LAUNDER asm volatile("" : "+v"(fr), "+v"(fq))
__device__ __forceinline__ v4u pack8(const f32x4 a, const f32x4 b) { v4u w; w.x = cvt_pk_bf16(a[0], a[1]); w.y = cvt_pk_bf16(a[2], a[3]); w.z = cvt_pk_bf16(b[0], b[1]); w.w = cvt_pk_bf16(b[2], b[3]); return w; }
__device__ __forceinline__ void unpack8(const v4u w, f32x4& a, f32x4& b) { a = (f32x4){bf_lo(w.x), bf_hi(w.x), bf_lo(w.y), bf_hi(w.y)}; b = (f32x4){bf_lo(w.z), bf_hi(w.z), bf_lo(w.w), bf_hi(w.w)}; }
template <int ACT> __device__ __forceinline__ f32x4 act4(f32x4 v) {
    f32x4 o;
#pragma unroll
    for (int i = 0; i < 4; ++i) o[i] = ACT == 1 ? siluf_(v[i]) : (ACT == 2 ? geluf_(v[i]) : (ACT == 3 ? sigmoidf_(v[i]) : v[i]));
    return o;
}
struct EpiIn {
    static constexpr bool PERM = true;
    unsigned char* ws;
    template <int ACT> __device__ __forceinline__ void plain(EPI_ARGS, bf16* O, int ldc, int colt) const {
        const float* bias = (const float*)(ws + WS_BINP);
        const int row0 = u.pm * BM + wr * 64 + fr, cw = wc * 32 + 8 * fq;
        f32x4 bv[2][2];
#pragma unroll
        for (int bj = 0; bj < 2; ++bj)
#pragma unroll
            for (int n = 0; n < 2; ++n) bv[bj][n] = *(const f32x4*)(bias + u.pn * BM + bj * HALF + cw + 4 * n);
#pragma unroll
        for (int ai = 0; ai < 2; ++ai)
#pragma unroll
            for (int m = 0; m < 4; ++m) { bf16* rowp = O + (size_t)(row0 + ai * HALF + m * 16) * ldc + colt + cw;
#pragma unroll
                for (int bj = 0; bj < 2; ++bj) *(v4u*)(rowp + bj * HALF) = pack8(act4<ACT>(acc[ai][bj][m][0] + bv[bj][0]), act4<ACT>(acc[ai][bj][m][1] + bv[bj][1]));
                asm volatile("" ::: "memory"); }
    }
    __device__ __forceinline__ void operator()(EPI_ARGS) const {
        EPI_LAUNDER;
        const float* bias = (const float*)(ws + WS_BINP); bf16* US = (bf16*)(ws + WS_US); bf16* SZA = (bf16*)(ws + WS_SZA); bf16* UZ = (bf16*)(ws + WS_UZ); bf16* GVT = (bf16*)(ws + WS_GV);
        float* STATS = (float*)(ws + WS_STATS); bf16* SGA = (bf16*)(ws + WS_SGA); bf16* SGB = (bf16*)(ws + WS_SGB);
        const int pn = u.pn, cw = wc * 32 + 8 * fq;
        if (pn < 2) {
            f32x4 bv[2][2];
#pragma unroll
            for (int bj = 0; bj < 2; ++bj)
#pragma unroll
                for (int n = 0; n < 2; ++n) bv[bj][n] = *(const f32x4*)(bias + pn * BM + bj * HALF + cw + 4 * n);
#pragma unroll
            for (int ai = 0; ai < 2; ++ai)
#pragma unroll
                for (int m = 0; m < 4; ++m) {
                    const int row = u.pm * BM + ai * HALF + wr * 64 + m * 16 + fr; int inst, j;
                    if (row >= NTOK) { const int rc = row - NTOK; inst = (rc >> 8) * 16 + ((rc & 255) >> 4); j = rc & 15; }
                    else { inst = 512 + (row >> 11) * 128 + ((row & 2047) >> 4); j = row & 15; }
#pragma unroll
                    for (int bj = 0; bj < 2; ++bj) { const int ch = pn * BM + bj * HALF + cw, g = ch >> 4, h0 = ch & 15;
                        *(v4u*)(US + ((size_t)(g * NINST + inst) * 512 + j * 16 + h0)) = pack8(acc[ai][bj][m][0] + bv[bj][0], acc[ai][bj][m][1] + bv[bj][1]); }
                    asm volatile("" ::: "memory");
                }
        } else if (pn < 4) { plain<1>(acc, u, wr, wc, fr, fq, SZA, 512, (pn - 2) * BM);
        } else if (pn < 8) {
            f32x4 bv[2][2];
#pragma unroll
            for (int bj = 0; bj < 2; ++bj)
#pragma unroll
                for (int n = 0; n < 2; ++n) bv[bj][n] = *(const f32x4*)(bias + pn * BM + bj * HALF + cw + 4 * n);
#pragma unroll
            for (int ai = 0; ai < 2; ++ai)
#pragma unroll
                for (int m = 0; m < 4; ++m) { const int row = u.pm * BM + ai * HALF + wr * 64 + m * 16 + fr;
                    const f32x4 a0 = act4<2>(acc[ai][0][m][0] + bv[0][0]) * act4<1>(acc[ai][1][m][0] + bv[1][0]);
                    const f32x4 a1 = act4<2>(acc[ai][0][m][1] + bv[0][1]) * act4<1>(acc[ai][1][m][1] + bv[1][1]);
                    *(v4u*)(UZ + (size_t)row * 512 + (pn - 4) * HALF + cw) = pack8(a0, a1); asm volatile("" ::: "memory"); }
        } else if (pn < 10) {
            f32x4 bv[2][2];
#pragma unroll
            for (int bj = 0; bj < 2; ++bj)
#pragma unroll
                for (int n = 0; n < 2; ++n) bv[bj][n] = *(const f32x4*)(bias + pn * BM + bj * HALF + cw + 4 * n);
#pragma unroll
            for (int ai = 0; ai < 2; ++ai)
#pragma unroll
                for (int m = 0; m < 4; ++m) { const int row = u.pm * BM + ai * HALF + wr * 64 + m * 16 + fr;
                    float s1 = 0.f, s2 = 0.f;
#pragma unroll
                    for (int bj = 0; bj < 2; ++bj) { const f32x4 g0 = act4<2>(acc[ai][bj][m][0] + bv[bj][0]), g1 = act4<2>(acc[ai][bj][m][1] + bv[bj][1]);
                        bf16* dst = GVT + ((size_t)(row >> 7) * 512 + (pn - 8) * BM + bj * HALF + cw) * 128 + (row & 127);
#pragma unroll
                        for (int e = 0; e < 4; ++e) { dst[(size_t)e * 128] = (bf16)f2bf(g0[e]); dst[(size_t)(4 + e) * 128] = (bf16)f2bf(g1[e]);
                            s1 += g0[e] + g1[e]; s2 += g0[e] * g0[e] + g1[e] * g1[e]; } }
                    s1 += __shfl_xor(s1, 16); s2 += __shfl_xor(s2, 16); s1 += __shfl_xor(s1, 32); s2 += __shfl_xor(s2, 32);
                    if (fq == 0) *(f32x2*)(STATS + ((size_t)row * 8 + (pn - 8) * 4 + wc) * 2) = (f32x2){s1, s2}; asm volatile("" ::: "memory"); }
        } else if (pn < 14) { plain<3>(acc, u, wr, wc, fr, fq, SGA, 1024, (pn - 10) * BM);
        } else { plain<3>(acc, u, wr, wc, fr, fq, SGB, 1024, (pn - 14) * BM); }
    }
};
struct EpiE {
    static constexpr bool PERM = false;
    float* E;
    __device__ __forceinline__ void operator()(EPI_ARGS) const {
        EPI_LAUNDER;
        const int row0 = u.pm * BM + wr * 64 + fr, col0 = wc * 32 + 4 * fq;
#pragma unroll
        for (int ai = 0; ai < 2; ++ai)
#pragma unroll
            for (int m = 0; m < 4; ++m) { float* rowp = E + (size_t)(row0 + ai * HALF + m * 16) * 256 + col0;
#pragma unroll
                for (int bj = 0; bj < 2; ++bj)
#pragma unroll
                    for (int n = 0; n < 2; ++n) *(f32x4*)(rowp + bj * HALF + n * 16) = acc[ai][bj][m][n]; }
    }
};
struct EpiY {
    static constexpr bool PERM = true;
    bf16* Gm;
    __device__ __forceinline__ void operator()(EPI_ARGS) const {
        EPI_LAUNDER;
        const int g = u.pn, cw = wc * 32 + 8 * fq, ji0 = (u.pm - (g * 18 + 2)) * BM + wr * 64 + fr;
#pragma unroll
        for (int ai = 0; ai < 2; ++ai)
#pragma unroll
            for (int m = 0; m < 4; ++m) { const int ji = ji0 + ai * HALF + m * 16;
#pragma unroll
                for (int bj = 0; bj < 2; ++bj) { const int n0 = bj * HALF + cw, t = n0 >> 4, h0 = n0 & 15;
                    *(v4u*)(Gm + ((size_t)g * NTOK + (size_t)ji * 16 + t) * 16 + h0) = pack8(act4<2>(acc[ai][bj][m][0]), act4<2>(acc[ai][bj][m][1])); } }
    }
};
struct EpiGlu {
    static constexpr bool PERM = true;
    unsigned char* ws; const float* gb;
    __device__ __forceinline__ void operator()(EPI_ARGS) const {
        EPI_LAUNDER;
        const bf16* Gm = (const bf16*)(ws + WS_GV); const bf16* SZA = (const bf16*)(ws + WS_SZA); bf16* YAB = (bf16*)(ws + WS_YAB);
        const int row0 = u.pm * BM + wr * 64 + fr, cw = wc * 32 + 8 * fq;
        f32x4 bv[2][2];
#pragma unroll
        for (int bj = 0; bj < 2; ++bj)
#pragma unroll
            for (int n = 0; n < 2; ++n) bv[bj][n] = *(const f32x4*)(gb + u.pn * BM + bj * HALF + cw + 4 * n);
#pragma unroll
        for (int ai = 0; ai < 2; ++ai)
#pragma unroll
            for (int m = 0; m < 4; ++m) { const int row = row0 + ai * HALF + m * 16;
#pragma unroll
                for (int bj = 0; bj < 2; ++bj) { const int col = u.pn * BM + bj * HALF + cw;
                    const v4u gw = *(const v4u*)(Gm + ((size_t)(col >> 4) * NTOK + row) * 16 + (col & 15)), zw = *(const v4u*)(SZA + (size_t)row * 512 + col);
                    f32x4 g0, g1, z0, z1; unpack8(gw, g0, g1); unpack8(zw, z0, z1);
                    const f32x4 y0 = g0 * act4<3>(acc[ai][bj][m][0] + bv[bj][0]) * z0, y1 = g1 * act4<3>(acc[ai][bj][m][1] + bv[bj][1]) * z1;
                    *(v4u*)(YAB + (size_t)row * 1024 + col) = pack8(y0, y1); } }
    }
};
template <bool SECOND> struct EpiAB {
    static constexpr bool PERM = true;
    unsigned char* ws;
    __device__ __forceinline__ void operator()(EPI_ARGS) const {
        EPI_LAUNDER;
        const bf16* SG = (const bf16*)(ws + (SECOND ? WS_SGB : WS_SGA)); bf16* M = (bf16*)(ws + WS_H);
        const int row0 = u.pm * BM + wr * 64 + fr, cw = wc * 32 + 8 * fq;
#pragma unroll
        for (int ai = 0; ai < 2; ++ai)
#pragma unroll
            for (int m = 0; m < 4; ++m) { const size_t ro = (size_t)(row0 + ai * HALF + m * 16) * 1024;
#pragma unroll
                for (int bj = 0; bj < 2; ++bj) { const int col = u.pn * BM + bj * HALF + cw;
                    f32x4 s0, s1; unpack8(*(const v4u*)(SG + ro + col), s0, s1);
                    f32x4 y0 = s0 * acc[ai][bj][m][0], y1 = s1 * acc[ai][bj][m][1];
                    if (SECOND) { f32x4 p0, p1; unpack8(*(const v4u*)(M + ro + col), p0, p1); y0 += p0; y1 += p1; }
                    *(v4u*)(M + ro + col) = pack8(y0, y1); } }
    }
};
struct EpiO {
    static constexpr bool PERM = false;
    const float* x; const float* mod; const float* bo; float* out;
    __device__ __forceinline__ void operator()(EPI_ARGS) const {
        EPI_LAUNDER;
        const int row0 = u.pm * BM + wr * 64 + fr, col0 = u.pn * BM + wc * 32 + 4 * fq;
        const float* gate = mod + (size_t)((u.pm * BM) >> 11) * 3072 + 2048;
        f32x4 bv[2][2], gv[2][2];
#pragma unroll
        for (int bj = 0; bj < 2; ++bj)
#pragma unroll
            for (int n = 0; n < 2; ++n) { bv[bj][n] = *(const f32x4*)(bo + col0 + bj * HALF + n * 16); gv[bj][n] = *(const f32x4*)(gate + col0 + bj * HALF + n * 16); }
#pragma unroll
        for (int ai = 0; ai < 2; ++ai)
#pragma unroll
            for (int m = 0; m < 4; ++m) { const size_t off = (size_t)(row0 + ai * HALF + m * 16) * DM + col0;
#pragma unroll
                for (int bj = 0; bj < 2; ++bj)
#pragma unroll
                    for (int n = 0; n < 2; ++n) { const f32x4 xv = *(const f32x4*)(x + off + bj * HALF + n * 16);
                        *(f32x4*)(out + off + bj * HALF + n * 16) = xv * ALPHA + gv[bj][n] * (acc[ai][bj][m][n] + bv[bj][n]); } }
    }
};

__device__ __forceinline__ void scan_phase(Frame& F, const Args& A) {
    const int gw = F.vcu * NWAVES + F.wave, NGW = F.G * NWAVES, p = F.lane;
    const float* E = (const float*)(A.ws + WS_H); bf16* US = (bf16*)(A.ws + WS_US); const float* A16 = (const float*)(A.ws + WS_A16);
    for (int it = gw; it < NGRP * NB * 2; it += NGW) {
        const int k = it & 1, b = (it >> 1) & 31, g = it >> 6;
        const float ar = A16[((k * 32 + g) * 64 + p) * 2], ai = A16[((k * 32 + g) * 64 + p) * 2 + 1];
        const float* Eg = E + (size_t)g * NINST * 256 + k * 128 + p; bf16* Sg = US + (size_t)g * NINST * 512 + 256 + k * 128 + p;
        float sr = 0.f, si = 0.f;
        for (int blk = 0; blk < 9; ++blk) {
            float er[16], ei[16];
#pragma unroll
            for (int q = 0; q < 16; ++q) { const int i = blk * 16 + q;
                const int inst = blk == 0 ? (b * 16 + (k ? 15 - q : q)) : (512 + b * 128 + (k ? 127 - (i - 16) : (i - 16)));
                er[q] = Eg[(size_t)inst * 256]; ei[q] = Eg[(size_t)inst * 256 + 64]; }
#pragma unroll
            for (int q = 0; q < 16; ++q) { const int i = blk * 16 + q;
                if (blk > 0) { const int inst = 512 + b * 128 + (k ? 127 - (i - 16) : (i - 16)); Sg[(size_t)inst * 512] = (bf16)f2bf(sr); Sg[(size_t)inst * 512 + 64] = (bf16)f2bf(si); }
                const float nr = ar * sr - ai * si + er[q], ni = ar * si + ai * sr + ei[q]; sr = nr; si = ni; }
        }
    }
}
__device__ __forceinline__ void mix_phase(Frame& F, const Args& A) {
    LAS float* RS = (LAS float*)(F.lds);
    LAS float* QS = RS + 128;
    LAS float* RW = QS + 128;
    LAS float* VM = RW + 128;
    const int nt = F.wave >> 1, ct = F.wave & 1, l31 = F.lane & 31, kg = F.lane >> 5;
    const bf16* WSG = (const bf16*)(A.ws + WS_WSG); const bf16* GVT = (const bf16*)(A.ws + WS_GV); const float* STATS = (const float*)(A.ws + WS_STATS);
    const bf16* UZ = (const bf16*)(A.ws + WS_UZ); bf16* YAB = (bf16*)(A.ws + WS_YAB);
    int gprev = -1; bf16x8 wf[8];
    for (int it = F.vcu; it < NCHUNK * NSG; it += F.G) {
        const int g = it & 7, chunk = it >> 3;
        if (g != gprev) {
            gprev = g;
#pragma unroll
            for (int s = 0; s < 8; ++s) wf[s] = *(const bf16x8*)(WSG + ((size_t)g * 128 + nt * 32 + l31) * 128 + 16 * s + 8 * kg);
            { const int n = F.tid >> 2, q = F.tid & 3; const float* wr_ = A.in[I_SGUW] + ((size_t)g * 128 + n) * 128 + q * 32; float s = 0.f;
#pragma unroll
              for (int j = 0; j < 8; ++j) { const f32x4 v = *(const f32x4*)(wr_ + 4 * j); s += (v.x + v.y) + (v.z + v.w); }
              s += __shfl_xor(s, 1); s += __shfl_xor(s, 2); if (q == 0) RW[n] = s; }
        }
        if (F.tid < 128) { const float* st = STATS + ((size_t)chunk * 128 + F.tid) * 16; float s1 = 0.f, s2 = 0.f;
#pragma unroll
            for (int j = 0; j < 4; ++j) { const f32x4 v = *(const f32x4*)(st + 4 * j); s1 += v.x + v.z; s2 += v.y + v.w; }
            const float mean = s1 * (1.f / 512.f), var = s2 * (1.f / 512.f) - mean * mean, rstd = 1.f / sqrtf(fmaxf(var, 0.f) + LN_EPS);
            RS[F.tid] = rstd; QS[F.tid] = -mean * rstd; }
        __syncthreads();
        f32x16 acc;
#pragma unroll
        for (int r = 0; r < 16; ++r) acc[r] = 0.f;
        const bf16* gv = GVT + ((size_t)chunk * 512 + g * 64 + ct * 32 + l31) * 128 + 8 * kg;
        v4u raw[8];
#pragma unroll
        for (int s = 0; s < 8; ++s) raw[s] = *(const v4u*)(gv + 16 * s);
#pragma unroll
        for (int s = 0; s < 8; ++s) {
            const f32x4 r0 = *(const LAS f32x4*)(RS + 16 * s + 8 * kg), r1 = *(const LAS f32x4*)(RS + 16 * s + 8 * kg + 4);
            const f32x4 q0 = *(const LAS f32x4*)(QS + 16 * s + 8 * kg), q1 = *(const LAS f32x4*)(QS + 16 * s + 8 * kg + 4);
            f32x4 a, b; unpack8(raw[s], a, b);
            const v4u nb = pack8(a * r0 + q0, b * r1 + q1);
            acc = __builtin_amdgcn_mfma_f32_32x32x16_bf16(wf[s], __builtin_bit_cast(bf16x8, nb), acc, 0, 0, 0);
        }
#pragma unroll
        for (int r = 0; r < 16; ++r) { const int n = nt * 32 + (r & 3) + 8 * (r >> 2) + 4 * kg; VM[n * 68 + ct * 32 + l31] = acc[r]; }
        __syncthreads();
#pragma unroll
        for (int q = 0; q < 2; ++q) { const int idx = F.tid + q * 512, n = idx >> 3, c0 = (idx & 7) * 8, ch = g * 64 + c0; const size_t tok = (size_t)chunk * 128 + n;
            const f32x4 d0 = *(const LAS f32x4*)(VM + n * 68 + c0), d1 = *(const LAS f32x4*)(VM + n * 68 + c0 + 4);
            const f32x4 lg0 = *(const f32x4*)(A.in[I_SLNG] + ch), lg1 = *(const f32x4*)(A.in[I_SLNG] + ch + 4), lb0 = *(const f32x4*)(A.in[I_SLNB] + ch), lb1 = *(const f32x4*)(A.in[I_SLNB] + ch + 4);
            const float rw = RW[n], bs = A.in[I_SGUB][g * 128 + n];
            f32x4 u0, u1; unpack8(*(const v4u*)(UZ + tok * 512 + ch), u0, u1);
            const f32x4 y0 = u0 * (lg0 * d0 + lb0 * rw + bs), y1 = u1 * (lg1 * d1 + lb1 * rw + bs);
            *(v4u*)(YAB + tok * 1024 + 512 + ch) = pack8(y0, y1); }
        __syncthreads();
    }
}
__device__ __forceinline__ void final_ln(Frame& F, const Args& A) {
    const int gw = F.vcu * NWAVES + F.wave, NGW = F.G * NWAVES;
    for (int m = gw; m < NTOK; m += NGW) {
        f32x4* xr = (f32x4*)(A.out + (size_t)m * DM) + F.lane;
        f32x4 v[4]; float s = 0.f;
#pragma unroll
        for (int j = 0; j < 4; ++j) { v[j] = xr[64 * j]; s += (v[j].x + v[j].y) + (v[j].z + v[j].w); }
        const float mean = wave_sum(s) * (1.f / DM); float s2 = 0.f;
#pragma unroll
        for (int j = 0; j < 4; ++j) { v[j] = v[j] - mean; s2 += (v[j].x * v[j].x + v[j].y * v[j].y) + (v[j].z * v[j].z + v[j].w * v[j].w); }
        const float rstd = 1.f / sqrtf(wave_sum(s2) * (1.f / DM) + LN_EPS);
#pragma unroll
        for (int j = 0; j < 4; ++j) { const f32x4 lg = *((const f32x4*)A.in[I_LNG] + F.lane + 64 * j), lb = *((const f32x4*)A.in[I_LNB] + F.lane + 64 * j); xr[64 * j] = v[j] * rstd * lg + lb; }
    }
}


#ifndef DBG_AFTER
#define DBG_AFTER -1
#endif
#ifndef DBG_SEL
#define DBG_SEL 25
#endif
__device__ __forceinline__ float bfe(const bf16* p, size_t i) { return __builtin_bit_cast(float, (unsigned)p[i] << 16); }
__device__ __forceinline__ void dump_phase(Frame& F, const Args& A) {
    const size_t gt = (size_t)blockIdx.x * NWAVES * 64 + F.tid, NT = (size_t)F.G * NWAVES * 64, N = (size_t)NTOK * DM;
    unsigned char* ws = A.ws;
    for (size_t i = gt; i < N; i += NT) {
        float v = 0.f;
        if (DBG_AFTER == 1) { v = bfe((const bf16*)(ws + WS_H), i) + bfe((const bf16*)(ws + WS_TG), i & (4u * 1024 * 1024 - 1)) + bfe((const bf16*)(ws + WS_WIN), i & (4u * 1024 * 1024 - 1)) + ((const float*)(ws + WS_MOD))[i % (33 * 3072)]; }
        if (DBG_AFTER == 2) { v = 0.f;
            if (DBG_SEL & 1) v += bfe((const bf16*)(ws + WS_SZA), i >> 1);
            if (DBG_SEL & 2) v += bfe((const bf16*)(ws + WS_UZ), i >> 1);
            if (DBG_SEL & 4) v += bfe((const bf16*)(ws + WS_GV), i >> 1);
            if (DBG_SEL & 8) v += bfe((const bf16*)(ws + WS_SGA), i);
            if (DBG_SEL & 16) v += bfe((const bf16*)(ws + WS_SGB), i);
            if (DBG_SEL & 32) v += bfe((const bf16*)(ws + WS_US), (i >> 8) * 512 + (i & 255));
            if (DBG_SEL & 64) v += ((const float*)(ws + WS_STATS))[i & (1024 * 1024 - 1)]; }
        if (DBG_AFTER == 3) { v = ((const float*)(ws + WS_H))[i % ((size_t)32 * 4608 * 256)]; }
        if (DBG_AFTER == 4) { v = bfe((const bf16*)(ws + WS_US), i) + bfe((const bf16*)(ws + WS_YAB), i); }
        if (DBG_AFTER == 5) { v = bfe((const bf16*)(ws + WS_GV), i >> 1); }
        if (DBG_AFTER == 6) { v = bfe((const bf16*)(ws + WS_YAB), i); }
        if (DBG_AFTER == 7 || DBG_AFTER == 8) { v = bfe((const bf16*)(ws + WS_H), i); }
        A.out[i] = v;
    }
}

__global__ void __launch_bounds__(NWAVES * 64, 2) skel_fwd(Args A) {
    extern __shared__ __attribute__((aligned(16))) unsigned char lds[];
    Frame F;
    F.lds = (LAS unsigned char*)lds;
    F.MISC = (volatile LAS unsigned*)(F.lds + MISC_OFF);
    F.tid = threadIdx.x; F.lane = F.tid & 63; F.wave = __builtin_amdgcn_readfirstlane(F.tid >> 6);
    F.G = gridDim.x; { const int bx = blockIdx.x; F.vcu = (F.G % 8 == 0) ? (bx % 8) * (F.G / 8) + bx / 8 : bx; }
    for (int u = F.tid; u < (LDS_BYTES - LDSCTL_OFF) / 4; u += NWAVES * 64) ((LAS unsigned*)(F.lds + LDSCTL_OFF))[u] = 0u;
    __syncthreads();
    XcdBarrier bar; bar.bar = (unsigned*)(A.ws + WS_CTL) + CW_BAR; bar.x = 0; bar.st = nullptr;
    if (N_LAUNCHES == 1) bar = xcd_barrier_post((unsigned*)(A.ws + WS_CTL) + CW_BAR, F.MISC + 8);
    const int lo = A.ph_lo, hi = A.ph_hi;
#ifndef PH_MASK
#define PH_MASK 0x7ff
#endif
#define IN(k) ((((PH_MASK) >> (k)) & 1) && lo <= (k) && (k) < hi && (DBG_AFTER < 0 || (k) <= DBG_AFTER))
#define SEAM(k) do { if (IN(k) && IN((k) + 1)) xcd_barrier(bar); } while (0)
    const int bx = (int)blockIdx.x;
    unsigned char* ws = A.ws;

    if (IN(0)) { p0_prep(F, A); } SEAM(0);
    if (IN(1)) { p1_rows(F, A); } SEAM(1);
    if (IN(2)) {
        pg8::Gemm g{(const char*)(ws + WS_H), (const char*)(ws + WS_WIN)};
        #if defined(DBG_PLAINONLY)
        SchedIn S; S.so.init(NTOK, 2560, F.G, bx); S.G = F.G; S.c = bx;
#else
        SchedIn S; S.so.init(NTOK, DIN, F.G, bx); S.G = F.G; S.c = bx;
#endif
        EpiIn E{ws};
        pg8::gemm_phase<EpiIn, SchedIn, true, DM, 2 * DM, 32, DM>(F.lds + RING_OFF, g, S, E);
    } SEAM(2);
    if (IN(3)) {
        pg8::Gemm g{(const char*)(ws + WS_US), (const char*)(ws + WS_WSUM)};
        SchedGrp S{F.G, bx, 18, 0, 32 * 18};
        EpiE E{(float*)(ws + WS_H)};
        pg8::gemm_phase<EpiE, SchedGrp, true, 256, 1024, 32, 256>(F.lds + RING_OFF, g, S, E);
    } SEAM(3);
    if (IN(4)) { scan_phase(F, A); __syncthreads(); mix_phase(F, A); } SEAM(4);
    if (IN(5)) {
        pg8::Gemm g{(const char*)(ws + WS_US), (const char*)(ws + WS_TG)};
        SchedGrp S{F.G, bx, 16, 2, 32 * 16};
        EpiY E{(bf16*)(ws + WS_GV)};
        pg8::gemm_phase<EpiY, SchedGrp, true, 512, 1024, 32, 512>(F.lds + RING_OFF, g, S, E);
    } SEAM(5);
    if (IN(6)) {
        pg8::Gemm g{(const char*)(ws + WS_GV), (const char*)(ws + WS_WGLU)};
        pg8::StaticOrder S; S.init(NTOK, 512, F.G, bx);
        EpiGlu E{ws, A.in[I_GLUB]};
        pg8::gemm_phase<EpiGlu, pg8::StaticOrder, true, 512, 32, 32u * NTOK, 512>(F.lds + RING_OFF, g, S, E);
    } SEAM(6);
    if (IN(7)) {
        pg8::Gemm g{(const char*)(ws + WS_YAB), (const char*)(ws + WS_WAB)};
        pg8::StaticOrder S; S.init(NTOK, DM, F.G, bx);
        EpiAB<false> E{ws};
        pg8::gemm_phase<EpiAB<false>, pg8::StaticOrder, true, 512, 2048, 32, 1024>(F.lds + RING_OFF, g, S, E);
    } SEAM(7);
    if (IN(8)) {
        pg8::Gemm g{(const char*)(ws + WS_YAB) + 1024, (const char*)(ws + WS_WAB) + 1024};
        pg8::StaticOrder S; S.init(NTOK, DM, F.G, bx);
        EpiAB<true> E{ws};
        pg8::gemm_phase<EpiAB<true>, pg8::StaticOrder, true, 512, 2048, 32, 1024>(F.lds + RING_OFF, g, S, E);
    } SEAM(8);
    if (IN(9)) {
        pg8::Gemm g{(const char*)(ws + WS_H), (const char*)(ws + WS_WO)};
        pg8::StaticOrder S; S.init(NTOK, DM, F.G, bx);
        EpiO E{A.in[I_X], (const float*)(ws + WS_MOD), A.in[I_BO], A.out};
        pg8::gemm_phase<EpiO, pg8::StaticOrder, true, DM, 2 * DM, 32, DM>(F.lds + RING_OFF, g, S, E);
    } SEAM(9);
    if (IN(10)) { final_ln(F, A); }
    if (DBG_AFTER >= 0 && lo <= 10 && 10 < hi) { dump_phase(F, A); }
#undef IN
#undef SEAM
}

extern "C" void kernel_launch(void* const* d_in, const int* in_sizes, int n_in, void* d_out, int out_size, void* d_ws, size_t ws_size, hipStream_t stream) {
    static int grid = 0;
    if (grid == 0) {
        if (n_in != 28 || in_sizes[0] != NTOK * DM || out_size != NTOK * DM || ws_size < WS_END) {
            fprintf(stderr, "kernel_launch: built for 28 inputs, x/out of %d floats, >= %zu bytes of workspace; got n_in %d, in0 %d, out %d, ws %zu; nothing launched\n", NTOK * DM, (size_t)WS_END, n_in, n_in > 0 ? in_sizes[0] : -1, out_size, ws_size); grid = -1; return; }
        int dev = 0, cus = 0, per_cu = 0;
        if (hipGetDevice(&dev) != hipSuccess || hipDeviceGetAttribute(&cus, hipDeviceAttributeMultiprocessorCount, dev) != hipSuccess) { fprintf(stderr, "kernel_launch: device query failed\n"); grid = -1; return; }
        if (hipFuncSetAttribute((const void*)skel_fwd, hipFuncAttributeMaxDynamicSharedMemorySize, LDS_BYTES) != hipSuccess) { fprintf(stderr, "kernel_launch: hipFuncSetAttribute failed\n"); grid = -1; return; }
        if (hipOccupancyMaxActiveBlocksPerMultiprocessor(&per_cu, (const void*)skel_fwd, NWAVES * 64, LDS_BYTES) != hipSuccess || per_cu < 1) {
            fprintf(stderr, "kernel_launch: occupancy query reports %d workgroups per CU; nothing launched\n", per_cu); (void)hipGetLastError(); grid = -1; return; }
        grid = cus;
    }
    if (grid < 0) return;
    if (hipMemsetAsync((char*)d_ws + WS_CTL, 0, CTL_ZERO_BYTES, stream) != hipSuccess) { fprintf(stderr, "kernel_launch: hipMemsetAsync failed\n"); return; }
    Args a{};
    for (int i = 0; i < 28; ++i) a.in[i] = (const float*)d_in[i];
    a.out = (float*)d_out; a.ws = (unsigned char*)d_ws;
    for (int li = 0; li < N_LAUNCHES; ++li) {
        a.ph_lo = (N_LAUNCHES == 1) ? 0 : li; a.ph_hi = (N_LAUNCHES == 1) ? NPH : li + 1;
        hipLaunchKernelGGL(skel_fwd, dim3(grid), dim3(NWAVES * 64), LDS_BYTES, stream, a);
        const hipError_t le = hipPeekAtLastError();
        if (le != hipSuccess) { fprintf(stderr, "kernel_launch: launch %d failed: %s\n", li, hipGetErrorName(le)); break; }
    }
}
```
